# Optimizing an MI355X kernel written in HIP

```python
import jax, jax.numpy as jnp
from jax import lax
import numpy as np

D_MODEL = 1024
BATCH = 2
SEQ = 8192
DEPTH = 1

ATTN_HEADS = 8
HEAD_DIM = 64
ATTN_WIDTH = ATTN_HEADS * HEAD_DIM
DILATED_PATTERNS = ((128, 1), (512, 4), (2048, 16))
POOL_WINDOWS = (2, 4, 8, 16)
POOL_GROUPS = len(POOL_WINDOWS)
POOL_WIDTH = D_MODEL // 2
POOL_GROUP_DIM = POOL_WIDTH // POOL_GROUPS
MIX_WIDTH = ATTN_WIDTH + POOL_WIDTH
IN_WIDTH = 3 * ATTN_WIDTH + POOL_WIDTH
MEM_LEN = 256
MEM_HEADS = 4
MEM_HEAD_DIM = 128
MEM_WIDTH = MEM_HEADS * MEM_HEAD_DIM
N_EXPERTS = 64
N_EXPERT_GROUPS = 8
TOPK_GROUPS = 4
TOP_K = 8
EXPERT_HIDDEN = 256
SHARED_HIDDEN = 256
ROUTED_SCALE = 2.5
MOE_BLOCK = 128
LN_EPS = 1e-5
NEG_INF = -1e30

kernel_name = 'hybrid_dilated_pool_moe_block'


def layer_norm(x, g, b):
    xf = x.astype(jnp.float32)
    mu = xf.mean(-1, keepdims=True)
    var = jnp.square(xf - mu).mean(-1, keepdims=True)
    y = (xf - mu) * lax.rsqrt(var + LN_EPS) * g.astype(jnp.float32) + b.astype(jnp.float32)
    return y.astype(x.dtype)


def alibi_slopes(n_heads):
    return 2.0 ** (-8.0 * jnp.arange(1, n_heads + 1, dtype=jnp.float32) / n_heads)


def _to_strided_blocks(a, dil, blk):
    B, T, H, hd = a.shape
    L = T // dil
    Lp = -(-L // blk) * blk
    a = a.reshape(B, L, dil, H, hd).transpose(0, 3, 2, 1, 4)
    a = jnp.pad(a, ((0, 0), (0, 0), (0, 0), (0, Lp - L), (0, 0)))
    return a.reshape(B, H, dil, Lp // blk, blk, hd)


def dilated_branch(q, k, v, slopes, window, dil):
    B, T, H, hd = q.shape
    steps = window // dil
    blk = steps
    L = T // dil
    qb, kb, vb = (_to_strided_blocks(a, dil, blk) for a in (q, k, v))
    nb = qb.shape[3]

    def with_prev(a):
        prev = jnp.pad(a[:, :, :, :-1], ((0, 0), (0, 0), (0, 0), (1, 0), (0, 0), (0, 0)))
        return jnp.concatenate([prev, a], axis=4)

    kk, vv = with_prev(kb), with_prev(vb)
    dist = jnp.arange(blk)[:, None] + blk - jnp.arange(2 * blk)[None, :]
    first = (jnp.arange(nb) == 0)[:, None, None] & (jnp.arange(2 * blk) < blk)[None, None, :]
    valid = (dist >= 0)[None] & (dist <= steps)[None] & ~first
    s = jnp.einsum('bhrnqd,bhrnkd->bhrnqk', qb, kk, preferred_element_type=jnp.float32) * (hd ** -0.5)
    s = s - slopes[None, :, None, None, None, None] * (dist * dil).astype(jnp.float32)
    s = jnp.where(valid, s, NEG_INF)
    lse = jax.nn.logsumexp(s, axis=-1)
    p = jnp.exp(s - lse[..., None])
    o = jnp.einsum('bhrnqk,bhrnkd->bhrnqd', p.astype(v.dtype), vv, preferred_element_type=jnp.float32)
    o = o.reshape(B, H, dil, nb * blk, hd)[:, :, :, :L].transpose(0, 3, 2, 1, 4).reshape(B, T, H, hd)
    lse = lse.reshape(B, H, dil, nb * blk)[:, :, :, :L].transpose(0, 3, 2, 1).reshape(B, T, H)
    return o, lse


def dilated_attention(q, k, v):
    slopes = alibi_slopes(q.shape[2])
    outs, lses = [], []
    for window, dil in DILATED_PATTERNS:
        o, lse = dilated_branch(q, k, v, slopes, window, dil)
        outs.append(o)
        lses.append(lse)
    wts = jax.nn.softmax(jnp.stack(lses), axis=0)
    return jnp.einsum('gbth,gbthd->bthd', wts, jnp.stack(outs))


def multiscale_pool(p, pool_w, pool_scale):
    B, T, _ = p.shape
    grp = p.astype(jnp.float32).reshape(B, T, POOL_GROUPS, POOL_GROUP_DIM)
    cs0 = jnp.pad(jnp.cumsum(grp, axis=1), ((0, 0), (1, 0), (0, 0), (0, 0)))
    pos = jnp.arange(T, dtype=jnp.float32)
    outs = []
    for g, w in enumerate(POOL_WINDOWS):
        upper = cs0[:, 1:, g]
        lower = jnp.pad(cs0[:, :T + 1 - w, g], ((0, 0), (w - 1, 0), (0, 0)))
        count = jnp.minimum(pos + 1.0, float(w))[None, :, None]
        outs.append((upper - lower) / count - grp[:, :, g])
    pooled = jnp.stack(outs, axis=2)
    mixed = jnp.einsum('btgc,gcd->btgd', pooled, pool_w.astype(jnp.float32))
    return (mixed.reshape(B, T, POOL_WIDTH) * pool_scale.astype(jnp.float32)).astype(p.dtype)


def hybrid_mixer(h, w_in, pool_w, pool_scale, w_out):
    B, T, _ = h.shape
    proj = h @ w_in
    q, k, v, p = jnp.split(proj, [ATTN_WIDTH, 2 * ATTN_WIDTH, 3 * ATTN_WIDTH], axis=-1)
    heads = lambda a: a.reshape(B, T, ATTN_HEADS, HEAD_DIM)
    attn = dilated_attention(heads(q), heads(k), heads(v)).reshape(B, T, ATTN_WIDTH).astype(h.dtype)
    pool = multiscale_pool(p, pool_w, pool_scale)
    return jnp.concatenate([attn, pool], axis=-1) @ w_out


def memory_cross_attention(h, mem, w_cq, w_ck, w_cv, w_co):
    B, T, _ = h.shape
    M = mem.shape[1]
    q = (h @ w_cq).reshape(B, T, MEM_HEADS, MEM_HEAD_DIM)
    k = (mem @ w_ck).reshape(B, M, MEM_HEADS, MEM_HEAD_DIM)
    v = (mem @ w_cv).reshape(B, M, MEM_HEADS, MEM_HEAD_DIM)
    s = jnp.einsum('bthd,bmhd->bhtm', q, k, preferred_element_type=jnp.float32) * (MEM_HEAD_DIM ** -0.5)
    p = jax.nn.softmax(s, axis=-1)
    o = jnp.einsum('bhtm,bmhd->bthd', p.astype(v.dtype), v).reshape(B, T, MEM_WIDTH)
    return o @ w_co


def moe_ffn(h, w_router, router_bias, exp_gate, exp_up, exp_down, sh_gate, sh_up, sh_down):
    B, T, D = h.shape
    N = B * T
    hf = h.reshape(N, D)
    scores = jax.nn.sigmoid(jnp.matmul(hf, w_router, preferred_element_type=jnp.float32))
    biased = scores + router_bias.astype(jnp.float32)
    per_group = N_EXPERTS // N_EXPERT_GROUPS
    group_score = lax.top_k(biased.reshape(N, N_EXPERT_GROUPS, per_group), 2)[0].sum(-1)
    _, top_groups = lax.top_k(group_score, TOPK_GROUPS)
    group_mask = jax.nn.one_hot(top_groups, N_EXPERT_GROUPS, dtype=jnp.float32).sum(1) > 0
    expert_mask = jnp.repeat(group_mask, per_group, axis=1)
    _, idx = lax.top_k(jnp.where(expert_mask, biased, NEG_INF), TOP_K)
    gates = jnp.take_along_axis(scores, idx, axis=1)
    gates = gates / gates.sum(-1, keepdims=True) * ROUTED_SCALE

    A = N * TOP_K
    flat_e = idx.reshape(A)
    order = jnp.argsort(flat_e)
    sorted_e = flat_e[order]
    tok = (order // TOP_K).astype(jnp.int32)
    counts = jnp.bincount(flat_e, length=N_EXPERTS)
    padded = (counts + MOE_BLOCK - 1) // MOE_BLOCK * MOE_BLOCK
    pad_ends = jnp.cumsum(padded)
    rank = jnp.arange(A) - (jnp.cumsum(counts) - counts)[sorted_e]
    dest = (pad_ends - padded)[sorted_e] + rank
    n_blocks = -(-A // MOE_BLOCK) + N_EXPERTS
    P = n_blocks * MOE_BLOCK
    buf_tok = jnp.zeros((P,), jnp.int32).at[dest].set(tok)
    buf_w = jnp.zeros((P,), jnp.float32).at[dest].set(gates.reshape(A)[order])
    block_expert = jnp.minimum(
        jnp.searchsorted(pad_ends, jnp.arange(n_blocks) * MOE_BLOCK, side='right'), N_EXPERTS - 1)

    def expert_block(args):
        tok_blk, e = args
        xb = hf[tok_blk]
        return (jax.nn.silu(xb @ exp_gate[e]) * (xb @ exp_up[e])) @ exp_down[e]

    y = lax.map(expert_block, (buf_tok.reshape(n_blocks, MOE_BLOCK), block_expert))
    routed = jnp.zeros((N, D), jnp.float32).at[buf_tok].add(
        y.reshape(P, D).astype(jnp.float32) * buf_w[:, None])
    shared = (jax.nn.silu(hf @ sh_gate) * (hf @ sh_up)) @ sh_down
    return (routed + shared.astype(jnp.float32)).astype(h.dtype).reshape(B, T, D)


def setup_inputs(seed: int = 0) -> dict:
    key = jax.random.key(seed)
    ks = jax.random.split(key, 26)
    f32 = jnp.float32
    beta = (8.0 * DEPTH) ** -0.25

    def nrm(k, shape, fan_in, scale=1.0):
        return jax.random.normal(k, shape, f32) * (scale * fan_in ** -0.5)

    def gain(k):
        return 1.0 + 0.02 * jax.random.normal(k, (DEPTH, D_MODEL), f32)

    def small(k, shape):
        return 0.02 * jax.random.normal(k, shape, f32)

    col_scale = jnp.concatenate([jnp.ones((2 * ATTN_WIDTH,), f32), jnp.full((ATTN_WIDTH,), beta, f32),
                                 jnp.ones((POOL_WIDTH,), f32)])
    return {
        'x': jax.random.normal(ks[0], (BATCH, SEQ, D_MODEL), f32),
        'mem': jax.random.normal(ks[1], (BATCH, MEM_LEN, D_MODEL), f32),
        'w_in': nrm(ks[2], (DEPTH, D_MODEL, IN_WIDTH), D_MODEL) * col_scale,
        'pool_w': nrm(ks[3], (DEPTH, POOL_GROUPS, POOL_GROUP_DIM, POOL_GROUP_DIM), POOL_GROUP_DIM),
        'pool_scale': 1.0 + 0.02 * jax.random.normal(ks[4], (DEPTH, POOL_WIDTH), f32),
        'w_out': nrm(ks[5], (DEPTH, MIX_WIDTH, D_MODEL), MIX_WIDTH, beta),
        'ln1_g': gain(ks[6]),
        'ln1_b': small(ks[7], (DEPTH, D_MODEL)),
        'w_cq': nrm(ks[8], (DEPTH, D_MODEL, MEM_WIDTH), D_MODEL),
        'w_ck': nrm(ks[9], (DEPTH, D_MODEL, MEM_WIDTH), D_MODEL),
        'w_cv': nrm(ks[10], (DEPTH, D_MODEL, MEM_WIDTH), D_MODEL, beta),
        'w_co': nrm(ks[11], (DEPTH, MEM_WIDTH, D_MODEL), MEM_WIDTH, beta),
        'ln2_g': gain(ks[12]),
        'ln2_b': small(ks[13], (DEPTH, D_MODEL)),
        'w_router': nrm(ks[14], (DEPTH, D_MODEL, N_EXPERTS), D_MODEL),
        'router_bias': 0.01 * jax.random.normal(ks[15], (DEPTH, N_EXPERTS), f32),
        'exp_gate': nrm(ks[16], (DEPTH, N_EXPERTS, D_MODEL, EXPERT_HIDDEN), D_MODEL),
        'exp_up': nrm(ks[17], (DEPTH, N_EXPERTS, D_MODEL, EXPERT_HIDDEN), D_MODEL),
        'exp_down': nrm(ks[18], (DEPTH, N_EXPERTS, EXPERT_HIDDEN, D_MODEL), EXPERT_HIDDEN, beta),
        'sh_gate': nrm(ks[19], (DEPTH, D_MODEL, SHARED_HIDDEN), D_MODEL),
        'sh_up': nrm(ks[20], (DEPTH, D_MODEL, SHARED_HIDDEN), D_MODEL),
        'sh_down': nrm(ks[21], (DEPTH, SHARED_HIDDEN, D_MODEL), SHARED_HIDDEN, beta),
        'ln3_g': gain(ks[22]),
        'ln3_b': small(ks[23], (DEPTH, D_MODEL)),
    }


def reference(x, mem, w_in, pool_w, pool_scale, w_out, ln1_g, ln1_b, w_cq, w_ck, w_cv, w_co,
              ln2_g, ln2_b, w_router, router_bias, exp_gate, exp_up, exp_down, sh_gate, sh_up,
              sh_down, ln3_g, ln3_b):
    alpha = (2.0 * DEPTH) ** 0.25
    for l in range(DEPTH):
        x = layer_norm(alpha * x + hybrid_mixer(x, w_in[l], pool_w[l], pool_scale[l], w_out[l]),
                       ln1_g[l], ln1_b[l])
        x = layer_norm(alpha * x + memory_cross_attention(x, mem, w_cq[l], w_ck[l], w_cv[l], w_co[l]),
                       ln2_g[l], ln2_b[l])
        x = layer_norm(alpha * x + moe_ffn(x, w_router[l], router_bias[l], exp_gate[l], exp_up[l],
                                           exp_down[l], sh_gate[l], sh_up[l], sh_down[l]),
                       ln3_g[l], ln3_b[l])
    return x
```

```cpp
#include <hip/hip_runtime.h>
#include <cstdio>
#include <cstdint>

namespace nv {
constexpr int D = 1024, B = 2, T = 8192, NTOK = B * T;
constexpr int H = 8, HD = 64, AW = 512, PW = 512, INW = 2048;
constexpr int ML = 256, MH = 4, MHD = 128, MW = 512;
constexpr int NE = 64, TOPK = 8, EH = 256;
constexpr int CAP = NTOK;
constexpr float ALPHA = 1.189207115002721f;
constexpr float LN_EPS = 1e-5f;

template <int NB, class P>
__global__ void __launch_bounds__(256) gemm_naive(P p, int N, int K) {
    const int z = blockIdx.z;
    const int M = p.rows(z);
    const int m0 = blockIdx.y * 64, n0 = blockIdx.x * 64;
    if (m0 >= M) return;
    __shared__ float As[16][65];
    __shared__ float Bs[NB][16][65];
    const int tid = threadIdx.x, tx = tid & 15, ty = tid >> 4;
    float acc[NB][4][4];
#pragma unroll
    for (int b = 0; b < NB; ++b)
#pragma unroll
        for (int i = 0; i < 4; ++i)
#pragma unroll
            for (int j = 0; j < 4; ++j) acc[b][i][j] = 0.f;
    const int ar = tid >> 2, ak = (tid & 3) * 4;
    const float* arow = (m0 + ar < M) ? p.arow(z, m0 + ar) : nullptr;
    const int bk = tid >> 4, bn = (tid & 15) * 4;
    for (int k0 = 0; k0 < K; k0 += 16) {
        float4 av = make_float4(0.f, 0.f, 0.f, 0.f);
        if (arow) av = *(const float4*)(arow + k0 + ak);
        As[ak + 0][ar] = av.x; As[ak + 1][ar] = av.y; As[ak + 2][ar] = av.z; As[ak + 3][ar] = av.w;
#pragma unroll
        for (int b = 0; b < NB; ++b) {
            const float4 bv = *(const float4*)(p.b(z, b) + (size_t)(k0 + bk) * p.ldb() + n0 + bn);
            Bs[b][bk][bn + 0] = bv.x; Bs[b][bk][bn + 1] = bv.y; Bs[b][bk][bn + 2] = bv.z; Bs[b][bk][bn + 3] = bv.w;
        }
        __syncthreads();
#pragma unroll
        for (int k = 0; k < 16; ++k) {
            float a[4];
#pragma unroll
            for (int i = 0; i < 4; ++i) a[i] = As[k][ty * 4 + i];
#pragma unroll
            for (int b = 0; b < NB; ++b) {
                float bb[4];
#pragma unroll
                for (int j = 0; j < 4; ++j) bb[j] = Bs[b][k][tx * 4 + j];
#pragma unroll
                for (int i = 0; i < 4; ++i)
#pragma unroll
                    for (int j = 0; j < 4; ++j) acc[b][i][j] = fmaf(a[i], bb[j], acc[b][i][j]);
            }
        }
        __syncthreads();
    }
#pragma unroll
    for (int i = 0; i < 4; ++i) {
        const int m = m0 + ty * 4 + i;
        if (m >= M) continue;
#pragma unroll
        for (int j = 0; j < 4; ++j) {
            const int n = n0 + tx * 4 + j;
            if (NB == 2) p.epi(z, m, n, acc[0][i][j], acc[NB - 1][i][j]);
            else p.epi(z, m, n, acc[0][i][j], 0.f);
        }
    }
}

struct PDense {
    const float* A; const float* Bm; float* C; int lda; int ldb_; int ldc; int M;
    __device__ int rows(int) const { return M; }
    __device__ const float* arow(int, int m) const { return A + (size_t)m * lda; }
    __device__ const float* b(int, int) const { return Bm; }
    __device__ int ldb() const { return ldb_; }
    __device__ void epi(int, int m, int n, float v, float) const { C[(size_t)m * ldc + n] = v; }
};
struct PDenseRes {
    const float* A; const float* Bm; const float* R; float* C; int lda; int ldb_; int ldc; int M;
    __device__ int rows(int) const { return M; }
    __device__ const float* arow(int, int m) const { return A + (size_t)m * lda; }
    __device__ const float* b(int, int) const { return Bm; }
    __device__ int ldb() const { return ldb_; }
    __device__ void epi(int, int m, int n, float v, float) const { C[(size_t)m * ldc + n] = ALPHA * R[(size_t)m * ldc + n] + v; }
};
struct PExpUp {
    const float* X; const int* cnt; const int* list_tok; const int* list_slot; const float* Wg; const float* Wu; float* Hb;
    __device__ int rows(int z) const { return cnt[z]; }
    __device__ const float* arow(int z, int m) const { return X + (size_t)list_tok[(size_t)z * CAP + m] * D; }
    __device__ const float* b(int z, int w) const { return (w == 0 ? Wg : Wu) + (size_t)z * D * EH; }
    __device__ int ldb() const { return EH; }
    __device__ void epi(int z, int m, int n, float g, float u) const {
        const int slot = list_slot[(size_t)z * CAP + m];
        Hb[(size_t)slot * EH + n] = g / (1.f + __expf(-g)) * u;
    }
};
struct PExpDown {
    const float* Hb; const int* cnt; const int* list_tok; const int* list_slot; const float* Wd; const float* gatew; float* Y;
    __device__ int rows(int z) const { return cnt[z]; }
    __device__ const float* arow(int z, int m) const { return Hb + (size_t)list_slot[(size_t)z * CAP + m] * EH; }
    __device__ const float* b(int z, int) const { return Wd + (size_t)z * EH * D; }
    __device__ int ldb() const { return D; }
    __device__ void epi(int z, int m, int n, float v, float) const {
        const int slot = list_slot[(size_t)z * CAP + m]; const int tok = list_tok[(size_t)z * CAP + m];
        atomicAdd(Y + (size_t)tok * D + n, v * gatew[slot]);
    }
};
struct PShUp {
    const float* X; const float* Wg; const float* Wu; float* Hs;
    __device__ int rows(int) const { return NTOK; }
    __device__ const float* arow(int, int m) const { return X + (size_t)m * D; }
    __device__ const float* b(int, int w) const { return w == 0 ? Wg : Wu; }
    __device__ int ldb() const { return EH; }
    __device__ void epi(int, int m, int n, float g, float u) const { Hs[(size_t)m * EH + n] = g / (1.f + __expf(-g)) * u; }
};
struct PShDown {
    const float* Hs; const float* Wd; float* Y;
    __device__ int rows(int) const { return NTOK; }
    __device__ const float* arow(int, int m) const { return Hs + (size_t)m * EH; }
    __device__ const float* b(int, int) const { return Wd; }
    __device__ int ldb() const { return D; }
    __device__ void epi(int, int m, int n, float v, float) const { atomicAdd(Y + (size_t)m * D + n, v); }
};

__device__ __forceinline__ float wave_sum(float v) {
#pragma unroll
    for (int o = 32; o > 0; o >>= 1) v += __shfl_xor(v, o);
    return v;
}
__device__ __forceinline__ float wave_max(float v) {
#pragma unroll
    for (int o = 32; o > 0; o >>= 1) v = fmaxf(v, __shfl_xor(v, o));
    return v;
}

__global__ void __launch_bounds__(64) dil_attn_naive(const float* __restrict__ proj, float* __restrict__ mix) {
    const int bt = blockIdx.x / H, h = blockIdx.x % H;
    const int b = bt / T, t = bt % T;
    const int lane = threadIdx.x;
    __shared__ float qs[HD];
    __shared__ float ps[3 * 129 + 5];
    __shared__ int   pos[3 * 129 + 5];
    qs[lane] = proj[(size_t)bt * INW + h * HD + lane];
    __syncthreads();
    const float slope = exp2f(-(float)(h + 1));
    const int NK = 3 * 129;
    float sc[7]; float mx = -3.0e38f;
#pragma unroll
    for (int i = 0; i < 7; ++i) {
        const int n = lane + i * 64; sc[i] = -3.0e38f;
        if (n < NK) {
            const int br = n / 129, j = n % 129; const int dil = br == 0 ? 1 : (br == 1 ? 4 : 16);
            const int s = t - j * dil;
            pos[n] = s;
            if (s >= 0) {
                const float* kp = proj + (size_t)(b * T + s) * INW + AW + h * HD;
                float dot = 0.f;
                for (int d = 0; d < HD; ++d) dot = fmaf(qs[d], kp[d], dot);
                sc[i] = dot * 0.125f - slope * (float)(j * dil);
            }
        }
        mx = fmaxf(mx, sc[i]);
    }
    mx = wave_max(mx);
    float sum = 0.f;
#pragma unroll
    for (int i = 0; i < 7; ++i) {
        const int n = lane + i * 64;
        if (n < NK) { const float e = (sc[i] > -1.0e38f) ? __expf(sc[i] - mx) : 0.f; ps[n] = e; sum += e; }
    }
    sum = wave_sum(sum);
    __syncthreads();
    float o = 0.f;
    for (int n = 0; n < NK; ++n) {
        const int s = pos[n];
        if (s >= 0) o = fmaf(ps[n], proj[(size_t)(b * T + s) * INW + 2 * AW + h * HD + lane], o);
    }
    mix[(size_t)bt * D + h * HD + lane] = o / sum;
}

__global__ void __launch_bounds__(512) pool_naive(const float* __restrict__ proj, const float* __restrict__ pool_w, const float* __restrict__ pool_scale, float* __restrict__ mix) {
    const int bt = blockIdx.x, b = bt / T, t = bt % T, c = threadIdx.x;
    __shared__ float pl[PW];
    const int g = c >> 7, w = 2 << g; const int cnt = (t + 1 < w) ? t + 1 : w;
    float s = 0.f;
    for (int i = 0; i < cnt; ++i) s += proj[(size_t)(b * T + t - i) * INW + 3 * AW + c];
    pl[c] = s / (float)cnt - proj[(size_t)bt * INW + 3 * AW + c];
    __syncthreads();
    const int dd = c & 127; float o = 0.f;
    for (int cc = 0; cc < 128; ++cc) o = fmaf(pl[g * 128 + cc], pool_w[((size_t)g * 128 + cc) * 128 + dd], o);
    mix[(size_t)bt * D + AW + c] = o * pool_scale[c];
}

__global__ void __launch_bounds__(256) ln_naive(const float* P, const float* __restrict__ g, const float* __restrict__ bta, float* Y) {
    const int row = blockIdx.x, tid = threadIdx.x;
    __shared__ float red[8];
    const float4 v = *(const float4*)(P + (size_t)row * D + tid * 4);
    float s = wave_sum(v.x + v.y + v.z + v.w);
    if ((tid & 63) == 0) red[tid >> 6] = s;
    __syncthreads();
    const float mu = (red[0] + red[1] + red[2] + red[3]) * (1.f / D);
    const float dx = v.x - mu, dy = v.y - mu, dz = v.z - mu, dw = v.w - mu;
    float q = wave_sum(dx * dx + dy * dy + dz * dz + dw * dw);
    if ((tid & 63) == 0) red[4 + (tid >> 6)] = q;
    __syncthreads();
    const float var = (red[4] + red[5] + red[6] + red[7]) * (1.f / D);
    const float rs = rsqrtf(var + LN_EPS);
    const float4 gg = *(const float4*)(g + tid * 4), bb = *(const float4*)(bta + tid * 4);
    float4 o; o.x = dx * rs * gg.x + bb.x; o.y = dy * rs * gg.y + bb.y; o.z = dz * rs * gg.z + bb.z; o.w = dw * rs * gg.w + bb.w;
    *(float4*)(Y + (size_t)row * D + tid * 4) = o;
}

__global__ void __launch_bounds__(64) xattn_naive(const float* __restrict__ qc, const float* __restrict__ kc, const float* __restrict__ vc, float* __restrict__ oc) {
    const int bt = blockIdx.x / MH, h = blockIdx.x % MH, b = bt / T, lane = threadIdx.x;
    __shared__ float qs[MHD];
    __shared__ float ps[ML];
    qs[lane] = qc[(size_t)bt * MW + h * MHD + lane]; qs[lane + 64] = qc[(size_t)bt * MW + h * MHD + lane + 64];
    __syncthreads();
    float sc[4]; float mx = -3.0e38f;
#pragma unroll
    for (int i = 0; i < 4; ++i) {
        const int m = lane + i * 64; const float* kp = kc + (size_t)(b * ML + m) * MW + h * MHD;
        float dot = 0.f;
        for (int d = 0; d < MHD; ++d) dot = fmaf(qs[d], kp[d], dot);
        sc[i] = dot * 0.08838834764831845f; mx = fmaxf(mx, sc[i]);
    }
    mx = wave_max(mx);
    float sum = 0.f;
#pragma unroll
    for (int i = 0; i < 4; ++i) { const float e = __expf(sc[i] - mx); ps[lane + i * 64] = e; sum += e; }
    sum = wave_sum(sum);
    __syncthreads();
    float o0 = 0.f, o1 = 0.f;
    for (int m = 0; m < ML; ++m) {
        const float* vp = vc + (size_t)(b * ML + m) * MW + h * MHD;
        o0 = fmaf(ps[m], vp[lane], o0); o1 = fmaf(ps[m], vp[lane + 64], o1);
    }
    oc[(size_t)bt * MW + h * MHD + lane] = o0 / sum; oc[(size_t)bt * MW + h * MHD + lane + 64] = o1 / sum;
}

__global__ void __launch_bounds__(256) router_naive(const float* __restrict__ X, const float* __restrict__ Wr, const float* __restrict__ rbias,
                                                    int* __restrict__ cnt, int* __restrict__ list_tok, int* __restrict__ list_slot, float* __restrict__ gatew) {
    const int tok = blockIdx.x * 4 + (threadIdx.x >> 6), lane = threadIdx.x & 63;
    const float* xr = X + (size_t)tok * D;
    float logit = 0.f;
    for (int k = 0; k < D; ++k) logit = fmaf(xr[k], Wr[(size_t)k * NE + lane], logit);
    const float score = 1.f / (1.f + __expf(-logit));
    const float bs = score + rbias[lane];
    int r = 0;
#pragma unroll
    for (int j = 1; j < 8; ++j) { const float o = __shfl_xor(bs, j); const int oi = lane ^ j; r += (o > bs) || (o == bs && oi < lane); }
    float gs = r < 2 ? bs : 0.f;
    gs += __shfl_xor(gs, 1); gs += __shfl_xor(gs, 2); gs += __shfl_xor(gs, 4);
    const int g = lane >> 3; int gr = 0;
#pragma unroll
    for (int gg = 0; gg < 8; ++gg) { const float o = __shfl(gs, gg * 8); gr += (o > gs) || (o == gs && gg < g); }
    const float mv = gr < 4 ? bs : -1e30f;
    int er = 0;
    for (int e = 0; e < 64; ++e) { const float o = __shfl(mv, e); er += (o > mv) || (o == mv && e < lane); }
    const bool sel = er < 8;
    const float ssum = wave_sum(sel ? score : 0.f);
    if (sel) {
        const int slot = tok * TOPK + er;
        const int pos = atomicAdd(cnt + lane, 1);
        list_tok[(size_t)lane * CAP + pos] = tok; list_slot[(size_t)lane * CAP + pos] = slot;
        gatew[slot] = score / ssum * 2.5f;
    }
}

__global__ void __launch_bounds__(256) final_naive(const float* __restrict__ X2, const float* __restrict__ Y, const float* __restrict__ g, const float* __restrict__ bta, float* __restrict__ out) {
    const int row = blockIdx.x, tid = threadIdx.x;
    __shared__ float red[8];
    const float4 a = *(const float4*)(X2 + (size_t)row * D + tid * 4), y = *(const float4*)(Y + (size_t)row * D + tid * 4);
    float4 v; v.x = ALPHA * a.x + y.x; v.y = ALPHA * a.y + y.y; v.z = ALPHA * a.z + y.z; v.w = ALPHA * a.w + y.w;
    float s = wave_sum(v.x + v.y + v.z + v.w);
    if ((tid & 63) == 0) red[tid >> 6] = s;
    __syncthreads();
    const float mu = (red[0] + red[1] + red[2] + red[3]) * (1.f / D);
    const float dx = v.x - mu, dy = v.y - mu, dz = v.z - mu, dw = v.w - mu;
    float q = wave_sum(dx * dx + dy * dy + dz * dz + dw * dw);
    if ((tid & 63) == 0) red[4 + (tid >> 6)] = q;
    __syncthreads();
    const float var = (red[4] + red[5] + red[6] + red[7]) * (1.f / D);
    const float rs = rsqrtf(var + LN_EPS);
    const float4 gg = *(const float4*)(g + tid * 4), bb = *(const float4*)(bta + tid * 4);
    float4 o; o.x = dx * rs * gg.x + bb.x; o.y = dy * rs * gg.y + bb.y; o.z = dz * rs * gg.z + bb.z; o.w = dw * rs * gg.w + bb.w;
    *(float4*)(out + (size_t)row * D + tid * 4) = o;
}
}

extern "C" void kernel_launch(void* const* d_in, const int* in_sizes, int n_in, void* d_out, int out_size, void* d_ws, size_t ws_size, hipStream_t stream) {
    using namespace nv;
    const float* x = (const float*)d_in[0];       const float* mem = (const float*)d_in[1];
    const float* w_in = (const float*)d_in[2];    const float* pool_w = (const float*)d_in[3];  const float* pool_scale = (const float*)d_in[4];
    const float* w_out = (const float*)d_in[5];   const float* ln1_g = (const float*)d_in[6];   const float* ln1_b = (const float*)d_in[7];
    const float* w_cq = (const float*)d_in[8];    const float* w_ck = (const float*)d_in[9];    const float* w_cv = (const float*)d_in[10];
    const float* w_co = (const float*)d_in[11];   const float* ln2_g = (const float*)d_in[12];  const float* ln2_b = (const float*)d_in[13];
    const float* w_router = (const float*)d_in[14]; const float* router_bias = (const float*)d_in[15];
    const float* exp_gate = (const float*)d_in[16]; const float* exp_up = (const float*)d_in[17]; const float* exp_down = (const float*)d_in[18];
    const float* sh_gate = (const float*)d_in[19];  const float* sh_up = (const float*)d_in[20];  const float* sh_down = (const float*)d_in[21];
    const float* ln3_g = (const float*)d_in[22];  const float* ln3_b = (const float*)d_in[23];
    float* out = (float*)d_out;
    char* ws = (char*)d_ws;
    const size_t MiB = 1024 * 1024;
    float* regA = (float*)ws;
    float* regB = (float*)(ws + 128 * MiB);
    float* regC = (float*)(ws + 192 * MiB);
    char* sm = ws + 256 * MiB;
    float* kc = (float*)sm;                 sm += 1 * MiB;
    float* vc = (float*)sm;                 sm += 1 * MiB;
    int* list_tok = (int*)sm;               sm += 4 * MiB;
    int* list_slot = (int*)sm;              sm += 4 * MiB;
    float* gatew = (float*)sm;              sm += MiB / 2;
    int* cnt = (int*)sm;                    sm += 4096;
    if ((size_t)(sm - ws) > ws_size) { fprintf(stderr, "workspace too small: need %zu have %zu\n", (size_t)(sm - ws), ws_size); }
    float* qc = out;
    float* oc = out + (size_t)NTOK * MW;
    float* hs = out;

    float* proj = regA; float* mix = regB; float* x1 = regC; float* x2 = regB; float* hb = regA; float* Y = regC;

    { PDense p{x, w_in, proj, D, INW, INW, NTOK}; gemm_naive<1, PDense><<<dim3(INW / 64, NTOK / 64, 1), 256, 0, stream>>>(p, INW, D); }
    dil_attn_naive<<<NTOK * H, 64, 0, stream>>>(proj, mix);
    pool_naive<<<NTOK, 512, 0, stream>>>(proj, pool_w, pool_scale, mix);
    { PDenseRes p{mix, w_out, x, x1, D, D, D, NTOK}; gemm_naive<1, PDenseRes><<<dim3(D / 64, NTOK / 64, 1), 256, 0, stream>>>(p, D, D); }
    ln_naive<<<NTOK, 256, 0, stream>>>(x1, ln1_g, ln1_b, x1);
    { PDense p{x1, w_cq, qc, D, MW, MW, NTOK}; gemm_naive<1, PDense><<<dim3(MW / 64, NTOK / 64, 1), 256, 0, stream>>>(p, MW, D); }
    { PDense p{mem, w_ck, kc, D, MW, MW, B * ML}; gemm_naive<1, PDense><<<dim3(MW / 64, B * ML / 64, 1), 256, 0, stream>>>(p, MW, D); }
    { PDense p{mem, w_cv, vc, D, MW, MW, B * ML}; gemm_naive<1, PDense><<<dim3(MW / 64, B * ML / 64, 1), 256, 0, stream>>>(p, MW, D); }
    xattn_naive<<<NTOK * MH, 64, 0, stream>>>(qc, kc, vc, oc);
    { PDenseRes p{oc, w_co, x1, x2, MW, D, D, NTOK}; gemm_naive<1, PDenseRes><<<dim3(D / 64, NTOK / 64, 1), 256, 0, stream>>>(p, D, MW); }
    ln_naive<<<NTOK, 256, 0, stream>>>(x2, ln2_g, ln2_b, x2);
    (void)hipMemsetAsync(cnt, 0, 256, stream);
    (void)hipMemsetAsync(Y, 0, (size_t)NTOK * D * 4, stream);
    router_naive<<<NTOK / 4, 256, 0, stream>>>(x2, w_router, router_bias, cnt, list_tok, list_slot, gatew);
    { PExpUp p{x2, cnt, list_tok, list_slot, exp_gate, exp_up, hb}; gemm_naive<2, PExpUp><<<dim3(EH / 64, CAP / 64, NE), 256, 0, stream>>>(p, EH, D); }
    { PExpDown p{hb, cnt, list_tok, list_slot, exp_down, gatew, Y}; gemm_naive<1, PExpDown><<<dim3(D / 64, CAP / 64, NE), 256, 0, stream>>>(p, D, EH); }
    { PShUp p{x2, sh_gate, sh_up, hs}; gemm_naive<2, PShUp><<<dim3(EH / 64, NTOK / 64, 1), 256, 0, stream>>>(p, EH, D); }
    { PShDown p{hs, sh_down, Y}; gemm_naive<1, PShDown><<<dim3(D / 64, NTOK / 64, 1), 256, 0, stream>>>(p, D, EH); }
    final_naive<<<NTOK, 256, 0, stream>>>(x2, Y, ln3_g, ln3_b, out);
}
```
